# Optimizing an MI355X kernel written in HIP

```python
import jax, jax.numpy as jnp
from jax import lax
import numpy as np

D_MODEL = 1024
BATCH = 8
SEQ = 4096
DEPTH = 1

CHUNK = 64
ATT_HEADS = 8
ATT_HEAD_DIM = 64
ATT_WIDTH = ATT_HEADS * ATT_HEAD_DIM
N_PREV_CHUNKS = 8
BAND_CHUNKS = N_PREV_CHUNKS + 1
REL_CLIP = 256
SSD_HEAD_DIM = 64
SSD_WIDTH = D_MODEL
SSD_HEADS = SSD_WIDTH // SSD_HEAD_DIM
SSD_GROUPS = 2
SSD_STATE = 128
SSD_CONV = 4
SSD_CHUNK = CHUNK
CONV_DIM = SSD_WIDTH + 2 * SSD_GROUPS * SSD_STATE
MIX_WIDTH = ATT_WIDTH + SSD_WIDTH
IN_PROJ = 3 * ATT_WIDTH + SSD_WIDTH + CONV_DIM + SSD_HEADS
SPLITS = [ATT_WIDTH, 2 * ATT_WIDTH, 3 * ATT_WIDTH,
          3 * ATT_WIDTH + SSD_WIDTH,
          3 * ATT_WIDTH + SSD_WIDTH + CONV_DIM]
D_FF = 4 * D_MODEL
EPS = 1e-5

kernel_name = "hymba_chunkattn_ssd_sqrelu_block"


def rmsnorm(x, w):
    xf = x.astype(jnp.float32)
    y = xf * lax.rsqrt(jnp.mean(xf * xf, axis=-1, keepdims=True) + EPS)
    return (y * w.astype(jnp.float32)).astype(x.dtype)


def chunk_band_attention(q, k, v, rel_bias):
    bsz, seq = q.shape[0], q.shape[1]
    nc = seq // CHUNK
    shp = (bsz, nc, CHUNK, ATT_HEADS, ATT_HEAD_DIM)
    q = q.reshape(shp)
    k = k.reshape(shp)
    v = v.reshape(shp)
    pad = ((0, 0), (N_PREV_CHUNKS, 0), (0, 0), (0, 0), (0, 0))
    kp = jnp.pad(k, pad)
    vp = jnp.pad(v, pad)
    kb = jnp.concatenate([kp[:, j:j + nc] for j in range(BAND_CHUNKS)], axis=2)
    vb = jnp.concatenate([vp[:, j:j + nc] for j in range(BAND_CHUNKS)], axis=2)
    scale = ATT_HEAD_DIM ** -0.5
    scores = jnp.einsum('bcqhd,bckhd->bhcqk', q, kb).astype(jnp.float32) * scale
    qi = jnp.arange(CHUNK)[:, None]
    kj = jnp.arange(BAND_CHUNKS * CHUNK)[None, :]
    rel = N_PREV_CHUNKS * CHUNK + qi - kj
    idx = jnp.clip(rel, -REL_CLIP, REL_CLIP) + REL_CLIP
    bias = jnp.transpose(rel_bias.astype(jnp.float32)[idx], (2, 0, 1))
    key_chunk = jnp.arange(nc)[:, None] - N_PREV_CHUNKS + jnp.arange(BAND_CHUNKS)[None, :]
    valid = jnp.repeat(key_chunk >= 0, CHUNK, axis=1)
    scores = scores + bias[None, :, None]
    scores = jnp.where(valid[None, None, :, None, :], scores, -1e30)
    probs = jax.nn.softmax(scores, axis=-1).astype(v.dtype)
    out = jnp.einsum('bhcqk,bckhd->bcqhd', probs, vb)
    return out.reshape(bsz, seq, ATT_WIDTH)


def causal_depthwise_conv(u, w, b):
    out = lax.conv_general_dilated(
        u, w[:, None, :].astype(u.dtype), window_strides=(1,),
        padding=[(SSD_CONV - 1, 0)], dimension_numbers=('NWC', 'WIO', 'NWC'),
        feature_group_count=u.shape[-1])
    return out + b.astype(u.dtype)


def ssd_scan(x, dt, A, Bm, Cm):
    bsz, seq = x.shape[0], x.shape[1]
    nc = seq // SSD_CHUNK
    L = SSD_CHUNK
    r = SSD_HEADS // SSD_GROUPS
    X = (x * dt[..., None]).reshape(bsz, nc, L, SSD_GROUPS, r, SSD_HEAD_DIM)
    a = jnp.moveaxis((dt * A).reshape(bsz, nc, L, SSD_GROUPS, r), 2, -1)
    a_cum = jnp.cumsum(a, axis=-1)
    Bc = Bm.reshape(bsz, nc, L, SSD_GROUPS, SSD_STATE)
    Cc = Cm.reshape(bsz, nc, L, SSD_GROUPS, SSD_STATE)
    tril = jnp.tril(jnp.ones((L, L), dtype=bool))
    seg = a_cum[..., :, None] - a_cum[..., None, :]
    decay_in = jnp.exp(jnp.where(tril, seg, -jnp.inf))
    cb = jnp.einsum('bclgn,bcsgn->bcgls', Cc, Bc)
    y_diag = jnp.einsum('bcgls,bcgrls,bcsgrp->bclgrp', cb, decay_in, X)
    decay_out = jnp.exp(a_cum[..., -1:] - a_cum)
    states = jnp.einsum('bcsgn,bcgrs,bcsgrp->bcgrpn', Bc, decay_out, X)
    chunk_decay = jnp.exp(a_cum[..., -1])

    def step(carry, inp):
        st, dec = inp
        return carry * dec[..., None, None] + st, carry

    init = jnp.zeros_like(states[:, 0])
    _, prev = lax.scan(step, init, (jnp.moveaxis(states, 1, 0), jnp.moveaxis(chunk_decay, 1, 0)))
    prev = jnp.moveaxis(prev, 0, 1)
    y_off = jnp.einsum('bclgn,bcgrpn,bcgrl->bclgrp', Cc, prev, jnp.exp(a_cum))
    return (y_diag + y_off).reshape(bsz, seq, SSD_HEADS, SSD_HEAD_DIM)


def ssd_mixer(z, xbc, dt_raw, conv_w, conv_b, dt_bias, a_log, d_skip, norm_w):
    bsz, seq = z.shape[0], z.shape[1]
    xbc = jax.nn.silu(causal_depthwise_conv(xbc, conv_w, conv_b)).astype(jnp.float32)
    xs = xbc[..., :SSD_WIDTH]
    Bm = xbc[..., SSD_WIDTH:SSD_WIDTH + SSD_GROUPS * SSD_STATE].reshape(bsz, seq, SSD_GROUPS, SSD_STATE)
    Cm = xbc[..., SSD_WIDTH + SSD_GROUPS * SSD_STATE:].reshape(bsz, seq, SSD_GROUPS, SSD_STATE)
    dt = jax.nn.softplus(dt_raw.astype(jnp.float32) + dt_bias.astype(jnp.float32))
    A = -jnp.exp(a_log.astype(jnp.float32))
    xh = xs.reshape(bsz, seq, SSD_HEADS, SSD_HEAD_DIM)
    y = ssd_scan(xh, dt, A, Bm, Cm) + d_skip.astype(jnp.float32)[:, None] * xh
    y = y.reshape(bsz, seq, SSD_WIDTH) * jax.nn.silu(z.astype(jnp.float32))
    yg = y.reshape(bsz, seq, SSD_GROUPS, SSD_WIDTH // SSD_GROUPS)
    yg = yg * lax.rsqrt(jnp.mean(yg * yg, axis=-1, keepdims=True) + EPS)
    y = yg.reshape(bsz, seq, SSD_WIDTH) * norm_w.astype(jnp.float32)
    return y.astype(z.dtype)


def setup_inputs(seed: int = 0) -> dict:
    key = jax.random.key(seed)
    ks = jax.random.split(key, 16)
    f32 = jnp.float32
    x = jax.random.normal(ks[0], (BATCH, SEQ, D_MODEL), f32)
    norm_mix_w = 1.0 + 0.05 * jax.random.normal(ks[1], (DEPTH, D_MODEL), f32)
    w_in = jax.random.normal(ks[2], (DEPTH, D_MODEL, IN_PROJ), f32) * D_MODEL ** -0.5
    rel_bias = 0.1 * jax.random.normal(ks[3], (DEPTH, 2 * REL_CLIP + 1, ATT_HEADS), f32)
    conv_w = jax.random.normal(ks[4], (DEPTH, SSD_CONV, CONV_DIM), f32) * SSD_CONV ** -0.5
    conv_b = 0.01 * jax.random.normal(ks[5], (DEPTH, CONV_DIM), f32)
    dt0 = jnp.exp(jax.random.uniform(ks[6], (DEPTH, SSD_HEADS), f32,
                                     minval=np.log(1e-3), maxval=np.log(1e-1)))
    dt_bias = dt0 + jnp.log(-jnp.expm1(-dt0))
    a_log = jnp.log(jax.random.uniform(ks[7], (DEPTH, SSD_HEADS), f32, minval=1.0, maxval=16.0))
    d_skip = 1.0 + 0.1 * jax.random.normal(ks[8], (DEPTH, SSD_HEADS), f32)
    ssd_norm_w = 1.0 + 0.05 * jax.random.normal(ks[9], (DEPTH, SSD_WIDTH), f32)
    w_out = jax.random.normal(ks[10], (DEPTH, MIX_WIDTH, D_MODEL), f32) * MIX_WIDTH ** -0.5
    norm_mlp_w = 1.0 + 0.05 * jax.random.normal(ks[11], (DEPTH, D_MODEL), f32)
    w_ff1 = jax.random.normal(ks[12], (DEPTH, D_MODEL, D_FF), f32) * D_MODEL ** -0.5
    w_ff2 = jax.random.normal(ks[13], (DEPTH, D_FF, D_MODEL), f32) * D_FF ** -0.5
    norm_final_w = 1.0 + 0.05 * jax.random.normal(ks[14], (D_MODEL,), f32)
    return {"x": x, "norm_mix_w": norm_mix_w, "w_in": w_in, "rel_bias": rel_bias,
            "conv_w": conv_w, "conv_b": conv_b, "dt_bias": dt_bias, "a_log": a_log,
            "d_skip": d_skip, "ssd_norm_w": ssd_norm_w, "w_out": w_out,
            "norm_mlp_w": norm_mlp_w, "w_ff1": w_ff1, "w_ff2": w_ff2,
            "norm_final_w": norm_final_w}


def reference(x, norm_mix_w, w_in, rel_bias, conv_w, conv_b, dt_bias, a_log, d_skip,
              ssd_norm_w, w_out, norm_mlp_w, w_ff1, w_ff2, norm_final_w):
    h = x
    for i in range(DEPTH):
        hn = rmsnorm(h, norm_mix_w[i])
        proj = hn @ w_in[i]
        q, k, v, z, xbc, dt_raw = jnp.split(proj, SPLITS, axis=-1)
        att = chunk_band_attention(q, k, v, rel_bias[i])
        ssd = ssd_mixer(z, xbc, dt_raw, conv_w[i], conv_b[i], dt_bias[i],
                        a_log[i], d_skip[i], ssd_norm_w[i])
        h = h + jnp.concatenate([att, ssd], axis=-1) @ w_out[i]
        hn = rmsnorm(h, norm_mlp_w[i])
        h = h + jnp.square(jax.nn.relu(hn @ w_ff1[i])) @ w_ff2[i]
    return rmsnorm(h, norm_final_w)
```

```cpp
#include <hip/hip_runtime.h>
#include <hip/hip_cooperative_groups.h>
#include <cstdio>
#include <cstdint>
namespace cg = cooperative_groups;

#define LAS __attribute__((address_space(3)))
typedef unsigned short bf16_t;
typedef short bf16x8 __attribute__((ext_vector_type(8)));
typedef short s16x4 __attribute__((ext_vector_type(4)));
typedef float f32x2 __attribute__((ext_vector_type(2)));
typedef float f32x4 __attribute__((ext_vector_type(4)));
typedef float f32x16 __attribute__((ext_vector_type(16)));
typedef unsigned u32x2 __attribute__((ext_vector_type(2)));
typedef unsigned u32x4 __attribute__((ext_vector_type(4)));
typedef __bf16 bf16x2_t __attribute__((ext_vector_type(2)));
typedef short v4i16_t __attribute__((ext_vector_type(4)));

constexpr int M = 32768, DM = 1024, NP = 4096, MIXW = 1536, FF = 4096, WIN_LD = 4112, SEQ = 4096;
constexpr float EPS = 1e-5f;
constexpr int PC_Q = 0, PC_K = 512, PC_V = 1024, PC_Z = 1536, PC_X = 2560, PC_B = 3584, PC_C = 3840;
constexpr size_t MiB = 1u << 20;
constexpr size_t WS_WIN = 0, WS_WOUT = 8 * MiB, WS_W1 = 12 * MiB, WS_W2 = 20 * MiB, WS_DT = 28 * MiB  , WS_SSQ = 30 * MiB, WS_HSQ = 34 * MiB  ,
                 WS_H2SQ = 36 * MiB  , WS_DTV = 38 * MiB  , WS_PROJ = 40 * MiB  , WS_MIX = 296 * MiB, WS_XN = 392 * MiB  ,
                 WS_XC = 392 * MiB  , WS_BAR = 488 * MiB  , WS_END = 489 * MiB;
constexpr int LDS_BYTES = 163840;
constexpr int NPHASE = 8;

__device__ __forceinline__ unsigned cvtpk(float lo, float hi) { f32x2 v = {lo, hi}; bf16x2_t b = __builtin_convertvector(v, bf16x2_t); return __builtin_bit_cast(unsigned, b); }
__device__ __forceinline__ float bf_lo(unsigned w) { return __uint_as_float(w << 16); }
__device__ __forceinline__ float bf_hi(unsigned w) { return __uint_as_float(w & 0xffff0000u); }
__device__ __forceinline__ float wave_sum(float v) {
#pragma unroll
    for (int o = 1; o < 64; o <<= 1) v += __shfl_xor(v, o);
    return v;
}
__device__ __forceinline__ int crow(int i, int hh) { return (i & 3) + 8 * (i >> 2) + 4 * hh; }
#define MFMA32(a, b, c) __builtin_amdgcn_mfma_f32_32x32x16_bf16((a), (b), (c), 0, 0, 0)
__device__ __forceinline__ s16x4 ds_tr(const LAS unsigned char* p) { return __builtin_bit_cast(s16x4, __builtin_amdgcn_ds_read_tr16_b64_v4i16((LAS v4i16_t*)p)); }
__device__ __forceinline__ bf16x8 cat8(s16x4 lo, s16x4 hi) { return __builtin_shufflevector(lo, hi, 0, 1, 2, 3, 4, 5, 6, 7); }
__device__ __forceinline__ bf16x8 pack8(float a0, float a1, float a2, float a3, float a4, float a5, float a6, float a7) {
    u32x4 p; p.x = cvtpk(a0, a1); p.y = cvtpk(a2, a3); p.z = cvtpk(a4, a5); p.w = cvtpk(a6, a7); return __builtin_bit_cast(bf16x8, p);
}

namespace pg8 {
constexpr int BM = 256, BK = 64, HALF = 128, HTB = HALF * BK * 2, STAGE_BYTES = 8 * HTB, NXCD = 8, WGM = 8;
__host__ __device__ __forceinline__ int lds_byte(int r, int c) { const int st = (r >> 4) * 2 + (c >> 5), rr = r & 15, cc = c & 31, ob = rr * 64 + cc * 2; return st * 1024 + (ob ^ (((ob >> 9) & 1) << 5)); }
__host__ __device__ __forceinline__ void stage_rc(int b, int& R, int& C) { const int st = b / 1024, sb = b % 1024, swz = sb ^ (((sb >> 9) & 1) << 5); R = (st >> 1) * 16 + swz / 64; C = (st & 1) * 32 + (swz % 64) / 2; }
__host__ __device__ __forceinline__ int perm32(int rho) { const int n = rho >> 4, i = rho & 15; return 8 * (i >> 2) + 4 * n + (i & 3); }
struct Unit { int pm, pn; };
struct Gemm { const bf16_t* A; const bf16_t* Bt; int M, N, K; };
struct StaticOrder {
    int nM, nN, nwg, G, c;
    __host__ __device__ void init(int M_, int N_, int G_, int c_) { nM = M_ / BM; nN = N_ / BM; nwg = nM * nN; G = G_; c = c_; }
    __host__ __device__ bool next(int i, Unit& u) const {
        const long L = (long)i * G + c; if (L >= nwg) return false;
        int wgid = (int)L; { const int q = nwg / NXCD, r = nwg % NXCD, xcd = wgid % NXCD, off = wgid / NXCD; wgid = (xcd < r ? xcd * (q + 1) : r * (q + 1) + (xcd - r) * q) + off; }
        const int nig = WGM * nN, gid = wgid / nig, fm = gid * WGM, gsz = (nM - fm) < WGM ? (nM - fm) : WGM;
        u.pm = fm + ((wgid % nig) % gsz); u.pn = (wgid % nig) / gsz; return true;
    }
};

struct EpiProj {
    static constexpr bool PERM = true, KSEG = false;
    bf16_t* O; int ldc;
    __device__ __forceinline__ void kseg(f32x4 (&)[2][2][4][2], int, int, int, const LAS float*) const {}
    __device__ __forceinline__ void unit_begin(LAS float*, const Unit&, int) const {}
    __device__ __forceinline__ void operator()(f32x4 (&acc)[2][2][4][2], const Unit& u, int wr, int wc, int fr, int fq, const LAS float* rt) const {
        const int row0 = u.pm * BM + wr * 64 + fr, col0 = u.pn * BM + wc * 32 + 8 * fq;
#pragma unroll
        for (int ai = 0; ai < 2; ++ai)
#pragma unroll
            for (int m = 0; m < 4; ++m) { bf16_t* rowp = O + (size_t)(row0 + ai * HALF + m * 16) * ldc + col0;
#pragma unroll
                for (int bj = 0; bj < 2; ++bj) { const f32x4 v0 = acc[ai][bj][m][0], v1 = acc[ai][bj][m][1];
                    u32x4 w; w.x = cvtpk(v0[0], v0[1]); w.y = cvtpk(v0[2], v0[3]); w.z = cvtpk(v1[0], v1[1]); w.w = cvtpk(v1[2], v1[3]);
                    *(u32x4*)(rowp + bj * HALF) = w; } }
    }
};
struct EpiFF1 {
    static constexpr bool PERM = true, KSEG = false;
    bf16_t* O; int ldc; const float* hsq;
    __device__ __forceinline__ void kseg(f32x4 (&)[2][2][4][2], int, int, int, const LAS float*) const {}
    __device__ __forceinline__ void unit_begin(LAS float*, const Unit&, int) const {}
    __device__ __forceinline__ void operator()(f32x4 (&acc)[2][2][4][2], const Unit& u, int wr, int wc, int fr, int fq, const LAS float* rt) const {
        const int row0 = u.pm * BM + wr * 64 + fr, col0 = u.pn * BM + wc * 32 + 8 * fq;
#pragma unroll
        for (int ai = 0; ai < 2; ++ai)
#pragma unroll
            for (int m = 0; m < 4; ++m) { const int row = row0 + ai * HALF + m * 16;
                const f32x4 q = *(const f32x4*)(hsq + (size_t)row * 16 + fq * 4);
                float s = (q[0] + q[1]) + (q[2] + q[3]); s += __shfl_xor(s, 16); s += __shfl_xor(s, 32);
                const float rr = rsqrtf(s * (1.0f / 1024.0f) + EPS);
                bf16_t* rowp = O + (size_t)row * ldc + col0;
#pragma unroll
                for (int bj = 0; bj < 2; ++bj) { f32x4 v0 = acc[ai][bj][m][0] * rr, v1 = acc[ai][bj][m][1] * rr;
#pragma unroll
                    for (int e = 0; e < 4; ++e) { v0[e] = fmaxf(v0[e], 0.f); v0[e] *= v0[e]; v1[e] = fmaxf(v1[e], 0.f); v1[e] *= v1[e]; }
                    u32x4 w; w.x = cvtpk(v0[0], v0[1]); w.y = cvtpk(v0[2], v0[3]); w.z = cvtpk(v1[0], v1[1]); w.w = cvtpk(v1[2], v1[3]);
                    *(u32x4*)(rowp + bj * HALF) = w; } }
    }
};
struct EpiOut {
    static constexpr bool PERM = false, KSEG = true;
    const float* x; float* hout; bf16_t* hb; float* hsq; const float* ssq;
    __device__ __forceinline__ void unit_begin(LAS float* rt, const Unit& u, int tid) const {
        const int row = tid >> 1, grpi = tid & 1;
        const f32x4* p = (const f32x4*)(ssq + (size_t)(u.pm * BM + row) * 32 + grpi * 16);
        const f32x4 a = p[0], b = p[1], c = p[2], d = p[3];
        const float s = (((a[0] + a[1]) + (a[2] + a[3])) + ((b[0] + b[1]) + (b[2] + b[3]))) + (((c[0] + c[1]) + (c[2] + c[3])) + ((d[0] + d[1]) + (d[2] + d[3])));
        rt[row * 2 + grpi] = rsqrtf(s * (1.0f / 512.0f) + EPS);
    }
    __device__ __forceinline__ void kseg(f32x4 (&acc)[2][2][4][2], int t, int wr, int fr, const LAS float* rt) const {
#pragma unroll
        for (int ai = 0; ai < 2; ++ai)
#pragma unroll
            for (int m = 0; m < 4; ++m) { const f32x2 rv = *(const LAS f32x2*)(rt + (ai * HALF + wr * 64 + m * 16 + fr) * 2);
                const float f = (t == 8) ? (1.0f / rv[0]) : (rv[0] / rv[1]);
#pragma unroll
                for (int bj = 0; bj < 2; ++bj)
#pragma unroll
                    for (int n = 0; n < 2; ++n) acc[ai][bj][m][n] *= f; }
    }
    __device__ __forceinline__ void operator()(f32x4 (&acc)[2][2][4][2], const Unit& u, int wr, int wc, int fr, int fq, const LAS float* rt) const {
        const int row0 = u.pm * BM + wr * 64 + fr, col0 = u.pn * BM + wc * 32 + 4 * fq;
#pragma unroll
        for (int ai = 0; ai < 2; ++ai)
#pragma unroll
            for (int m = 0; m < 4; ++m) { const int row = row0 + ai * HALF + m * 16; const float r1 = rt[(ai * HALF + wr * 64 + m * 16 + fr) * 2 + 1];
                float sq = 0.f;
#pragma unroll
                for (int bj = 0; bj < 2; ++bj)
#pragma unroll
                    for (int n = 0; n < 2; ++n) { const size_t off = (size_t)row * DM + col0 + bj * HALF + n * 16;
                        const f32x4 xv = *(const f32x4*)(x + off); const f32x4 v = acc[ai][bj][m][n] * r1 + xv;
                        u32x2 w; w.x = cvtpk(v[0], v[1]); w.y = cvtpk(v[2], v[3]); *(u32x2*)(hb + off) = w;
                        sq += (v[0] * v[0] + v[1] * v[1]) + (v[2] * v[2] + v[3] * v[3]); }
                sq += __shfl_xor(sq, 16); sq += __shfl_xor(sq, 32);
                if (fq == 0) hsq[(size_t)row * 16 + u.pn * 4 + wc] = sq; }
    }
};
struct EpiFF2 {
    static constexpr bool PERM = false, KSEG = false;
    const bf16_t* hb; bf16_t* h2b; float* sqo;
    __device__ __forceinline__ void kseg(f32x4 (&)[2][2][4][2], int, int, int, const LAS float*) const {}
    __device__ __forceinline__ void unit_begin(LAS float*, const Unit&, int) const {}
    __device__ __forceinline__ void operator()(f32x4 (&acc)[2][2][4][2], const Unit& u, int wr, int wc, int fr, int fq, const LAS float* rt) const {
        const int row0 = u.pm * BM + wr * 64 + fr, col0 = u.pn * BM + wc * 32 + 4 * fq;
#pragma unroll
        for (int ai = 0; ai < 2; ++ai)
#pragma unroll
            for (int m = 0; m < 4; ++m) { const int row = row0 + ai * HALF + m * 16; float sq = 0.f;
#pragma unroll
                for (int bj = 0; bj < 2; ++bj)
#pragma unroll
                    for (int n = 0; n < 2; ++n) { const size_t off = (size_t)row * DM + col0 + bj * HALF + n * 16;
                        const u32x2 hw = *(const u32x2*)(hb + off);
                        const f32x4 v = acc[ai][bj][m][n] + (f32x4){bf_lo(hw.x), bf_hi(hw.x), bf_lo(hw.y), bf_hi(hw.y)};
                        u32x2 w; w.x = cvtpk(v[0], v[1]); w.y = cvtpk(v[2], v[3]); *(u32x2*)(h2b + off) = w; sq += (v[0] * v[0] + v[1] * v[1]) + (v[2] * v[2] + v[3] * v[3]); }
                sq += __shfl_xor(sq, 16); sq += __shfl_xor(sq, 32);
                if (fq == 0) sqo[(size_t)row * 16 + u.pn * 4 + wc] = sq; }
    }
};

template <class Epi, bool ALIGN_EPI>
__device__ __forceinline__ void gemm_phase(LAS unsigned char* lds, const Gemm g, const StaticOrder& S, const Epi& E) {
    const int tid = threadIdx.x, wid = __builtin_amdgcn_readfirstlane(tid >> 6), lane = tid & 63, wr = wid >> 2, wc = wid & 3, fr = lane & 15, fq = lane >> 4;
    const int K = g.K, nt = K / BK;
    unsigned voffA[2], voffB[2];
#pragma unroll
    for (int i = 0; i < 2; ++i) { int R, C; stage_rc(tid * 16 + i * 8192, R, C); const int Rb = Epi::PERM ? ((R & ~31) + perm32(R & 31)) : R;
        voffA[i] = (unsigned)(R * K + C) * 2u; voffB[i] = (unsigned)(Rb * K + C) * 2u; }
    const size_t kstep = (size_t)(BK * 2);
    const size_t hstep = (size_t)HALF * K * 2;
    const size_t tstep = 2 * hstep;
    const unsigned ldsw = (unsigned)wid * 1024u;
    const int aoff = lds_byte(wr * 64 + fr, fq * 8), boff = lds_byte(wc * 32 + fr, fq * 8);
#define PG8_SA(b, h) (((b) * 2 + (h)) * HTB)
#define PG8_SB(b, h) ((4 + (b) * 2 + (h)) * HTB)
#define PG8_STAGE(bufoff, gbase, voff) do { _Pragma("unroll") for (int _i = 0; _i < 2; ++_i) \
        __builtin_amdgcn_global_load_lds((const unsigned*)((const char*)(gbase) + (voff)[_i]), (LAS unsigned*)(lds + (bufoff) + ldsw + _i * 8192), 16, 0, 0); } while (0)
#define PG8_LDA(dst, b, h) do { _Pragma("unroll") for (int m = 0; m < 4; ++m) _Pragma("unroll") for (int k = 0; k < 2; ++k) dst[m][k] = *(const LAS bf16x8*)(lds + PG8_SA(b, h) + aoff + m * 2048 + k * 1024); } while (0)
#define PG8_LDB(dst, b, h) do { _Pragma("unroll") for (int n = 0; n < 2; ++n) _Pragma("unroll") for (int k = 0; k < 2; ++k) dst[n][k] = *(const LAS bf16x8*)(lds + PG8_SB(b, h) + boff + n * 2048 + k * 1024); } while (0)
#define PG8_MMA(ai, bj, At, Bt) do { __builtin_amdgcn_s_setprio(1); _Pragma("unroll") for (int m = 0; m < 4; ++m) _Pragma("unroll") for (int n = 0; n < 2; ++n) _Pragma("unroll") for (int k = 0; k < 2; ++k) \
        acc[ai][bj][m][n] = __builtin_amdgcn_mfma_f32_16x16x32_bf16(Bt[n][k], At[m][k], acc[ai][bj][m][n], 0, 0, 0); __builtin_amdgcn_s_setprio(0); } while (0)
#define PG8_WAIT_V(n) asm volatile("s_waitcnt vmcnt(" #n ")" ::: "memory")
#define PG8_WAIT_L(n) asm volatile("s_waitcnt lgkmcnt(" #n ")" ::: "memory")
#define PG8_BAR __builtin_amdgcn_s_barrier()
#define PG8_SCHED __builtin_amdgcn_sched_barrier(0)
    Unit cur, nxt; int ui = 0;
    if (!S.next(0, cur)) return;
    f32x4 acc[2][2][4][2];
#pragma unroll
    for (int a = 0; a < 2; ++a)
#pragma unroll
        for (int b = 0; b < 2; ++b)
#pragma unroll
            for (int m = 0; m < 4; ++m)
#pragma unroll
                for (int n = 0; n < 2; ++n) acc[a][b][m][n] = (f32x4){0.f, 0.f, 0.f, 0.f};
    bf16x8 At[4][2], B0[2][2], B1[2][2];
    const char* cA = (const char*)g.A + (size_t)cur.pm * tstep; const char* cB = (const char*)g.Bt + (size_t)cur.pn * tstep;
    if constexpr (Epi::KSEG) E.unit_begin((LAS float*)(lds + STAGE_BYTES), cur, tid);
    PG8_STAGE(PG8_SB(0, 0), cB, voffB); PG8_STAGE(PG8_SB(0, 1), cB + hstep, voffB); PG8_STAGE(PG8_SA(0, 0), cA, voffA); PG8_STAGE(PG8_SA(0, 1), cA + hstep, voffA);
    if (wr == 1) PG8_BAR;
    PG8_WAIT_V(2); PG8_BAR;
    PG8_STAGE(PG8_SB(1, 0), cB + kstep, voffB); PG8_STAGE(PG8_SA(1, 0), cA + kstep, voffA); PG8_STAGE(PG8_SB(1, 1), cB + hstep + kstep, voffB);
    PG8_WAIT_V(6); PG8_BAR;
    for (;;) {
        const bool has_next = S.next(ui + 1, nxt);
        const char* nA = has_next ? (const char*)g.A + (size_t)nxt.pm * tstep : cA; const char* nB = has_next ? (const char*)g.Bt + (size_t)nxt.pn * tstep : cB;
        for (int t = 0; t < nt; t += 2) {
            const bool last = (t == nt - 2);
            const char* a1 = cA + (size_t)(t + 1) * kstep;
            const char* a2 = last ? nA : cA + (size_t)(t + 2) * kstep; const char* b2 = last ? nB : cB + (size_t)(t + 2) * kstep;
            const char* a3 = a2 + kstep; const char* b3 = b2 + kstep;
            if constexpr (Epi::KSEG) { if (t == 8 || t == 16) E.kseg(acc, t, wr, fr, (const LAS float*)(lds + STAGE_BYTES + (ui & 1) * 2048)); }
            PG8_LDB(B0, 0, 0); PG8_LDB(B1, 0, 1); PG8_SCHED; PG8_LDA(At, 0, 0); PG8_STAGE(PG8_SA(1, 1), a1 + hstep, voffA);
            PG8_WAIT_V(8); PG8_WAIT_L(0); PG8_BAR; PG8_MMA(0, 0, At, B0); PG8_MMA(0, 1, At, B1); PG8_BAR; PG8_SCHED;
            PG8_LDA(At, 0, 1); PG8_STAGE(PG8_SB(0, 0), b2, voffB); PG8_STAGE(PG8_SB(0, 1), b2 + hstep, voffB); PG8_STAGE(PG8_SA(0, 0), a2, voffA);
            PG8_WAIT_V(8); PG8_WAIT_L(0); PG8_BAR; PG8_MMA(1, 0, At, B0); PG8_MMA(1, 1, At, B1); PG8_BAR; PG8_SCHED;
            PG8_LDB(B0, 1, 0); PG8_LDB(B1, 1, 1); PG8_SCHED; PG8_LDA(At, 1, 0); PG8_STAGE(PG8_SA(0, 1), a2 + hstep, voffA);
            PG8_WAIT_V(8); PG8_WAIT_L(0); PG8_BAR; PG8_MMA(0, 0, At, B0); PG8_MMA(0, 1, At, B1); PG8_BAR; PG8_SCHED;
            PG8_LDA(At, 1, 1); PG8_STAGE(PG8_SB(1, 0), b3, voffB); PG8_STAGE(PG8_SB(1, 1), b3 + hstep, voffB); PG8_STAGE(PG8_SA(1, 0), a3, voffA);
            PG8_WAIT_V(8); PG8_WAIT_L(0); PG8_BAR; PG8_MMA(1, 0, At, B0); PG8_MMA(1, 1, At, B1); PG8_BAR; PG8_SCHED;
        }
        if constexpr (ALIGN_EPI) { if (wr == 0) PG8_BAR; }
        E(acc, cur, wr, wc, fr, fq, (const LAS float*)(lds + STAGE_BYTES + (ui & 1) * 2048));
        if (!has_next) break;
#pragma unroll
        for (int a = 0; a < 2; ++a)
#pragma unroll
            for (int b = 0; b < 2; ++b)
#pragma unroll
                for (int m = 0; m < 4; ++m)
#pragma unroll
                    for (int n = 0; n < 2; ++n) acc[a][b][m][n] = (f32x4){0.f, 0.f, 0.f, 0.f};
        cur = nxt; cA = nA; cB = nB; ++ui;
        if constexpr (Epi::KSEG) E.unit_begin((LAS float*)(lds + STAGE_BYTES + (ui & 1) * 2048), cur, tid);
        if constexpr (ALIGN_EPI) { if (wr == 1) PG8_BAR; }
    }
    PG8_WAIT_V(0);
    if constexpr (!ALIGN_EPI) { if (wr == 0) PG8_BAR; }
    PG8_BAR;
#undef PG8_SA
#undef PG8_SB
#undef PG8_STAGE
#undef PG8_LDA
#undef PG8_LDB
#undef PG8_MMA
#undef PG8_WAIT_V
#undef PG8_WAIT_L
#undef PG8_BAR
#undef PG8_SCHED
}
}

struct Args { const float* in[15]; float* out; unsigned char* ws; int ph_lo, ph_hi, p2mask, pad; };

__device__ __forceinline__ void phase_prep(const Args& a, LAS unsigned char* lds, int tid, int lane, int wave) {
    const float* __restrict__ x = a.in[0]; const float* __restrict__ nmw = a.in[1]; const float* __restrict__ w_in = a.in[2]; const float* __restrict__ w_out = a.in[10]; const float* __restrict__ nmlp = a.in[11];
    const float* w_ff1 = a.in[12]; const float* w_ff2 = a.in[13];
    bf16_t* WinT = (bf16_t*)(a.ws + WS_WIN); bf16_t* WoutT = (bf16_t*)(a.ws + WS_WOUT); bf16_t* W1T = (bf16_t*)(a.ws + WS_W1); bf16_t* W2T = (bf16_t*)(a.ws + WS_W2);
    bf16_t* __restrict__ xn = (bf16_t*)(a.ws + WS_XN); float* __restrict__ dtraw = (float*)(a.ws + WS_DT);
    LAS float* Wd = (LAS float*)(lds + 32768);
    {
        LAS float* scr = (LAS float*)(lds + wave * 8704);
        const int gw = blockIdx.x * 8 + wave, NGW = gridDim.x * 8;
#pragma unroll 1
        for (int it = gw; it < 6912; it += NGW) {
            const float* W; int K, N, ldw, mode, r; bf16_t* WT;
            if (it < 2048) { W = w_in; K = 1024; N = 4096; ldw = WIN_LD; WT = WinT; mode = 1; r = it; }
            else if (it < 2816) { W = w_out; K = 1536; N = 1024; ldw = 1024; WT = WoutT; mode = 3; r = it - 2048; }
            else if (it < 4864) { W = w_ff1; K = 1024; N = 4096; ldw = 4096; WT = W1T; mode = 2; r = it - 2816; }
            else { W = w_ff2; K = 4096; N = 1024; ldw = 1024; WT = W2T; mode = 0; r = it - 4864; }
            const int nblk = N / 32, kb = r / nblk, nb = r % nblk, k0 = kb * 64, n0 = nb * 32;
            float v[32];
#pragma unroll
            for (int i = 0; i < 32; ++i) { const int kk = 2 * i + (lane >> 5); v[i] = W[(size_t)(k0 + kk) * ldw + n0 + (lane & 31)]; }
#pragma unroll
            for (int i = 0; i < 32; ++i) { const int kk = 2 * i + (lane >> 5);
                float sc = 1.f; if (mode == 1) sc = (n0 < 512) ? 0.125f : 1.f; else if (mode == 2) sc = nmlp[k0 + kk]; else if (mode == 3) sc = (k0 + kk >= 512) ? a.in[9][k0 + kk - 512] : 1.f;
                scr[kk * 33 + (lane & 31)] = v[i] * sc; }
            asm volatile("s_waitcnt lgkmcnt(0)" ::: "memory");
            const int c = lane & 7;
#pragma unroll
            for (int j = 0; j < 4; ++j) { const int n = (lane >> 3) + 8 * j; const LAS float* sp = scr + (8 * c) * 33 + n;
                u32x4 o; o.x = cvtpk(sp[0], sp[33]); o.y = cvtpk(sp[2 * 33], sp[3 * 33]); o.z = cvtpk(sp[4 * 33], sp[5 * 33]); o.w = cvtpk(sp[6 * 33], sp[7 * 33]);
                *(u32x4*)(WT + (size_t)(n0 + n) * K + k0 + 8 * c) = o; }
            asm volatile("s_waitcnt lgkmcnt(0)" ::: "memory");
        }
        __syncthreads();
    }
#pragma unroll 4
    for (int e = tid; e < 1024 * 16; e += 512) { const int k = e >> 4, j = e & 15; Wd[k * 20 + j] = w_in[(size_t)k * WIN_LD + 4096 + j] * nmw[k]; }
    __syncthreads();
#pragma unroll 2
    for (int row = blockIdx.x * 8 + wave; row < M; row += gridDim.x * 8) {
        float xv[16], ac[16]; float ss = 0.f;
        const float* xr = x + (size_t)row * DM + lane;
#pragma unroll
        for (int m = 0; m < 16; ++m) { xv[m] = xr[m * 64]; ss += xv[m] * xv[m]; }
        const float rr = rsqrtf(wave_sum(ss) * (1.0f / 1024.0f) + EPS);
        bf16_t* xo = xn + (size_t)row * DM + lane;
#pragma unroll
        for (int m = 0; m < 16; ++m) xo[m * 64] = (bf16_t)(cvtpk(xv[m] * rr * nmw[m * 64 + lane], 0.f) & 0xffffu);
#pragma unroll
        for (int j = 0; j < 16; ++j) ac[j] = 0.f;
#pragma unroll
        for (int m = 0; m < 16; ++m) { const LAS f32x4* wp = (const LAS f32x4*)(Wd + (m * 64 + lane) * 20);
            const f32x4 w0 = wp[0], w1 = wp[1], w2 = wp[2], w3 = wp[3]; const float xx = xv[m];
#pragma unroll
            for (int e = 0; e < 4; ++e) { ac[e] += xx * w0[e]; ac[4 + e] += xx * w1[e]; ac[8 + e] += xx * w2[e]; ac[12 + e] += xx * w3[e]; }
            if ((m & 3) == 3) asm volatile("" ::: "memory"); }
#pragma unroll
        for (int i = 0; i < 8; ++i) { const bool up = (lane & 32) != 0; const float send = up ? ac[i] : ac[i + 8], keep = up ? ac[i + 8] : ac[i]; ac[i] = keep + __shfl_xor(send, 32); }
#pragma unroll
        for (int i = 0; i < 4; ++i) { const bool up = (lane & 16) != 0; const float send = up ? ac[i] : ac[i + 4], keep = up ? ac[i + 4] : ac[i]; ac[i] = keep + __shfl_xor(send, 16); }
#pragma unroll
        for (int i = 0; i < 2; ++i) { const bool up = (lane & 8) != 0; const float send = up ? ac[i] : ac[i + 2], keep = up ? ac[i + 2] : ac[i]; ac[i] = keep + __shfl_xor(send, 8); }
        { const bool up = (lane & 4) != 0; const float send = up ? ac[0] : ac[1], keep = up ? ac[1] : ac[0]; ac[0] = keep + __shfl_xor(send, 4); }
        ac[0] += __shfl_xor(ac[0], 2); ac[0] += __shfl_xor(ac[0], 1);
        if ((lane & 3) == 0) dtraw[(size_t)row * 16 + (lane >> 2)] = ac[0] * rr;
    }
}

__device__ __forceinline__ void attn_unit(const bf16_t* __restrict__ proj, const float* __restrict__ rel_bias, bf16_t* __restrict__ mix, int u, LAS unsigned char* lds, int lane, int wave) {
    const int b = u >> 6, c = u & 63, h = wave, r = lane & 31, hh = lane >> 5;
    const int blk = (lane >> 4) & 1, q4 = (lane & 15) >> 2, p4 = lane & 3;
    const size_t tok0 = (size_t)b * SEQ + (size_t)c * 64;
    LAS unsigned char* wl = lds + wave * 12288;
    LAS float* tb = (LAS float*)(wl + 9216);
    for (int t = lane; t < 320; t += 64) tb[t] = rel_bias[(t + 193) * 8 + h];
    bf16x8 qf[2][4];
#pragma unroll
    for (int qb = 0; qb < 2; ++qb)
#pragma unroll
        for (int s = 0; s < 4; ++s) qf[qb][s] = *(const bf16x8*)(proj + (tok0 + qb * 32 + r) * NP + PC_Q + h * 64 + 16 * s + 8 * hh);
    f32x16 o[2][2];
#pragma unroll
    for (int i = 0; i < 2; ++i)
#pragma unroll
        for (int j = 0; j < 2; ++j)
#pragma unroll
            for (int e = 0; e < 16; ++e) o[i][j][e] = 0.f;
    float mrun[2] = {-1e30f, -1e30f}, lrun[2] = {0.f, 0.f};
    const int j0 = (c < 8) ? (8 - c) : 0;
    const int nsteps = (9 - j0) * 2;
    bf16x8 kfn[4]; u32x4 vpn[4];
#define ATT_LOAD(st) do { const int _j = j0 + ((st) >> 1), _kb = (st) & 1; const size_t _kt = tok0 + (size_t)(_j * 64 + _kb * 32) - 512; \
        _Pragma("unroll") for (int s = 0; s < 4; ++s) kfn[s] = *(const bf16x8*)(proj + (_kt + r) * NP + PC_K + h * 64 + 16 * s + 8 * hh); \
        _Pragma("unroll") for (int i = 0; i < 4; ++i) { const int idx = lane + 64 * i; vpn[i] = *(const u32x4*)(proj + (_kt + (idx >> 3)) * NP + PC_V + h * 64 + (idx & 7) * 8); } } while (0)
    ATT_LOAD(0);
    for (int st = 0; st < nsteps; ++st) {
        const int j = j0 + (st >> 1), kb = st & 1;
        bf16x8 kf[4];
#pragma unroll
        for (int s = 0; s < 4; ++s) kf[s] = kfn[s];
        LAS unsigned char* vb = wl + (st & 1) * 4608;
#pragma unroll
        for (int i = 0; i < 4; ++i) { const int idx = lane + 64 * i; *(LAS u32x4*)(vb + (idx >> 3) * 144 + (idx & 7) * 16) = vpn[i]; }
        if (st + 1 < nsteps) ATT_LOAD(st + 1);
        f32x16 sc[2];
#pragma unroll
        for (int qb = 0; qb < 2; ++qb) {
#pragma unroll
            for (int e = 0; e < 16; ++e) sc[qb][e] = 0.f;
#pragma unroll
            for (int s = 0; s < 4; ++s) sc[qb] = MFMA32(kf[s], qf[qb][s], sc[qb]);
        }
        if (j <= 3) { const float cb = tb[319];
#pragma unroll
            for (int qb = 0; qb < 2; ++qb)
#pragma unroll
                for (int e = 0; e < 16; ++e) sc[qb][e] += cb;
        } else {
#pragma unroll
            for (int qb = 0; qb < 2; ++qb) { const int base = 512 + qb * 32 + r - (j * 64 + kb * 32) + 63;
#pragma unroll
                for (int e = 0; e < 16; ++e) { int t = base - crow(e, hh); t = t > 319 ? 319 : t; sc[qb][e] += tb[t]; } }
        }
        bf16x8 pf[2][2];
#pragma unroll
        for (int qb = 0; qb < 2; ++qb) {
            float mx = sc[qb][0];
#pragma unroll
            for (int e = 1; e < 16; ++e) mx = fmaxf(mx, sc[qb][e]);
            mx = fmaxf(mx, __shfl_xor(mx, 32));
            const float mnew = fmaxf(mrun[qb], mx);
            const float alpha = __expf(mrun[qb] - mnew);
            mrun[qb] = mnew;
            float ps = 0.f;
#pragma unroll
            for (int e = 0; e < 16; ++e) { const float p = __expf(sc[qb][e] - mnew); sc[qb][e] = p; ps += p; }
            lrun[qb] = lrun[qb] * alpha + ps;
#pragma unroll
            for (int db = 0; db < 2; ++db)
#pragma unroll
                for (int e = 0; e < 16; ++e) o[db][qb][e] *= alpha;
            pf[qb][0] = pack8(sc[qb][0], sc[qb][1], sc[qb][2], sc[qb][3], sc[qb][4], sc[qb][5], sc[qb][6], sc[qb][7]);
            pf[qb][1] = pack8(sc[qb][8], sc[qb][9], sc[qb][10], sc[qb][11], sc[qb][12], sc[qb][13], sc[qb][14], sc[qb][15]);
        }
#pragma unroll
        for (int db = 0; db < 2; ++db)
#pragma unroll
            for (int s = 0; s < 2; ++s) {
                const LAS unsigned char* pa = vb + (16 * s + 4 * hh + q4) * 144 + (db * 32 + 16 * blk + 4 * p4) * 2;
                const bf16x8 vf = cat8(ds_tr(pa), ds_tr(pa + 8 * 144));
#pragma unroll
                for (int qb = 0; qb < 2; ++qb) o[db][qb] = MFMA32(vf, pf[qb][s], o[db][qb]);
            }
    }
#undef ATT_LOAD
#pragma unroll
    for (int qb = 0; qb < 2; ++qb) {
        const float l = lrun[qb] + __shfl_xor(lrun[qb], 32);
        const float inv = 1.0f / l;
        bf16_t* orow = mix + (tok0 + qb * 32 + r) * MIXW + h * 64;
#pragma unroll
        for (int db = 0; db < 2; ++db)
#pragma unroll
            for (int qd = 0; qd < 4; ++qd) { u32x2 w; w.x = cvtpk(o[db][qb][4 * qd] * inv, o[db][qb][4 * qd + 1] * inv); w.y = cvtpk(o[db][qb][4 * qd + 2] * inv, o[db][qb][4 * qd + 3] * inv);
                *(u32x2*)(orow + db * 32 + 8 * qd + 4 * hh) = w; }
    }
}

__device__ __forceinline__ float fast_silu(float v) { return v * __builtin_amdgcn_rcpf(1.0f + __expf(-v)); }
__device__ __forceinline__ void conv_unit(const Args& a, int u, int tid, int lane, int wave) {
    const bf16_t* __restrict__ proj = (const bf16_t*)(a.ws + WS_PROJ); bf16_t* __restrict__ xc = (bf16_t*)(a.ws + WS_XC);
    const float* dtraw = (const float*)(a.ws + WS_DT); float* dtv = (float*)(a.ws + WS_DTV); float* acg = (float*)(a.ws + WS_HSQ); float* wsg = (float*)(a.ws + WS_H2SQ);
    const float* conv_w = a.in[4]; const float* conv_b = a.in[5];
    const int c = u & 63; const size_t tok0 = (size_t)u * 64;
#pragma unroll
    for (int hi = 0; hi < 2; ++hi) { const int h = 2 * wave + hi; const size_t gi = (tok0 + lane) * 16 + h;
        const float xx = dtraw[gi] + a.in[6][h]; const float dt = (xx > 20.f) ? xx : log1pf(__expf(xx));
        float ac = dt * (-__expf(a.in[7][h]));
#pragma unroll
        for (int d = 1; d < 64; d <<= 1) { const float t = __shfl_up(ac, d); if (lane >= d) ac += t; }
        const float atot = __shfl(ac, 63);
        dtv[gi] = dt; acg[gi] = ac; wsg[gi] = dt * __expf(atot - ac); }
#pragma unroll
    for (int it = 0; it < 3; ++it) { const int item = tid + 512 * it, cg = item % 192, ts = item / 192;
        u32x4 raw[11];
#pragma unroll
        for (int i = 0; i < 11; ++i) { if (c == 0 && ts == 0 && i < 3) raw[i] = (u32x4){0u, 0u, 0u, 0u};
            else raw[i] = *(const u32x4*)(proj + ((long)tok0 + ts * 8 + i - 3) * NP + PC_X + cg * 8); }
        float wk[4][8], bb[8];
#pragma unroll
        for (int k = 0; k < 4; ++k) { const f32x4 w0 = *(const f32x4*)(conv_w + k * 1536 + cg * 8), w1 = *(const f32x4*)(conv_w + k * 1536 + cg * 8 + 4);
#pragma unroll
            for (int e = 0; e < 4; ++e) { wk[k][e] = w0[e]; wk[k][4 + e] = w1[e]; } }
        { const f32x4 w0 = *(const f32x4*)(conv_b + cg * 8), w1 = *(const f32x4*)(conv_b + cg * 8 + 4);
#pragma unroll
          for (int e = 0; e < 4; ++e) { bb[e] = w0[e]; bb[4 + e] = w1[e]; } }
        float win[11][8];
#pragma unroll
        for (int i = 0; i < 11; ++i) { win[i][0] = bf_lo(raw[i].x); win[i][1] = bf_hi(raw[i].x); win[i][2] = bf_lo(raw[i].y); win[i][3] = bf_hi(raw[i].y);
            win[i][4] = bf_lo(raw[i].z); win[i][5] = bf_hi(raw[i].z); win[i][6] = bf_lo(raw[i].w); win[i][7] = bf_hi(raw[i].w); }
#pragma unroll
        for (int tt = 0; tt < 8; ++tt) { float v[8];
#pragma unroll
            for (int e = 0; e < 8; ++e) { v[e] = bb[e];
#pragma unroll
                for (int k = 0; k < 4; ++k) v[e] += wk[k][e] * win[tt + k][e];
                v[e] = fast_silu(v[e]); }
            *(bf16x8*)(xc + (tok0 + ts * 8 + tt) * 1536 + cg * 8) = pack8(v[0], v[1], v[2], v[3], v[4], v[5], v[6], v[7]); }
    }
}

__device__ __forceinline__ void glds16(const void* gsrc, unsigned lds_dst) { unsigned keep;
    asm volatile("s_mov_b32 %0, m0\n\ts_mov_b32 m0, %2\n\ts_nop 0\n\tglobal_load_lds_dwordx4 %1, off\n\ts_mov_b32 m0, %0" : "=&s"(keep) : "v"(gsrc), "s"(lds_dst) : "memory"); }
constexpr int SB_STR = 272;
constexpr int L_IMG = 40960, L_OX = 0, L_OB = 8192, L_OC = 24576, L_S0 = 3 * L_IMG, L_S1 = L_S0 + 17408, L_ARR = L_S1 + 17408, L_SSD_END = L_ARR + 3 * 768;
static_assert(L_SSD_END <= LDS_BYTES - 16, "SSD LDS map");
#define LDSV(T, off) (*(const LAS T*)(lds + (off)))

__device__ __forceinline__ void ssd_unit(const Args& a, int u, LAS unsigned char* lds, int tid, int lane, int wave) {
    const bf16_t* __restrict__ proj = (const bf16_t*)(a.ws + WS_PROJ); const bf16_t* __restrict__ xc = (const bf16_t*)(a.ws + WS_XC);
    const float* __restrict__ dtg = (const float*)(a.ws + WS_DTV); const float* __restrict__ acg = (const float*)(a.ws + WS_HSQ); const float* __restrict__ wsg = (const float*)(a.ws + WS_H2SQ);
    bf16_t* __restrict__ mix = (bf16_t*)(a.ws + WS_MIX); float* __restrict__ ssq = (float*)(a.ws + WS_SSQ);
    const int b = u >> 4, h = u & 15, g = h >> 3;
    const int r = lane & 31, hh = lane >> 5, blk = (lane >> 4) & 1, q4 = (lane & 15) >> 2, p4 = lane & 3;
    const float Dh = a.in[8][h];
    const size_t tokb = (size_t)b * SEQ;
    const int team = wave >> 2, tw = wave & 3, lb = (wave >> 1) & 1, pb = wave & 1, nb = wave >> 1;
    unsigned dmaoff[10];
#pragma unroll
    for (int it = 0; it < 10; ++it) { const int wl = tw * 10 + it; int row, col;
        if (wl < 8) { const int slot = wl * 64 + lane; row = slot >> 3; col = h * 64 + (((slot & 7) ^ (row & 7)) << 3); }
        else if (wl < 24) { const int slot = (wl - 8) * 64 + lane; row = slot >> 4; col = 1024 + g * 128 + (((slot & 15) ^ (row & 15)) << 3); }
        else { const int slot = (wl - 24) * 64 + lane; row = slot >> 4; col = 1280 + g * 128 + (((slot & 15) ^ (row & 15)) << 3); }
        dmaoff[it] = (unsigned)(row * 1536 + col) * 2u; }
    const unsigned rbase = (unsigned)(lb * 32 + 4 * hh);
    const unsigned zoff0 = (rbase * (unsigned)NP + (unsigned)(r & ~1)) * 2u, moff0 = (rbase * (unsigned)MIXW + (unsigned)r) * 2u;
    const int jj = (lane >> 1) & 15; const unsigned qoff = (rbase + (jj & 3) + 8 * (jj >> 2)) * 32u * 4u;
    const int aRow = r * 256 + ((hh ^ (r & 15)) << 4);
    const int aS = (pb * 32 + r) * SB_STR + hh * 16;
    const int chx = 4 * pb + 2 * blk + (p4 >> 1), chb = 4 * nb + 2 * blk + (p4 >> 1), sub8 = (p4 & 1) * 8;
    const int aXt2 = (4 * hh + q4) * 128 + ((chx ^ (4 * hh + q4)) << 4) + sub8;
    const int aXlo = (8 * hh + q4) * 128 + ((chx ^ q4) << 4) + sub8, aXhi = (8 * hh + q4 + 4) * 128 + ((chx ^ (q4 + 4)) << 4) + sub8;
    const int aBlo = (8 * hh + q4) * 256 + ((chb ^ (8 * hh + q4)) << 4) + sub8, aBhi = (8 * hh + q4 + 4) * 256 + ((chb ^ (8 * hh + q4 + 4)) << 4) + sub8;
    const int aSw = (pb * 32 + r) * SB_STR + (nb * 32 + 4 * hh) * 2;
#define SSD_DMA(cc) do { const char* _src = (const char*)(xc + (tokb + (size_t)(cc) * 64) * 1536); const unsigned _dst = (unsigned)(size_t)lds + (unsigned)(((cc) % 3) * L_IMG); \
        _Pragma("unroll") for (int it = 0; it < 10; ++it) { const int wl = tw * 10 + it; \
            glds16(_src + dmaoff[it], _dst + wl * 1024); } } while (0)
    for (int e = tid; e < 17408 / 4; e += 512) ((LAS unsigned*)(lds + L_S0))[e] = 0u;
    if (team == 0) SSD_DMA(0);
    if (wave == 0) { LAS float* ar = (LAS float*)(lds + L_ARR); const size_t gi = (tokb + lane) * 16 + h; ar[lane] = dtg[gi]; ar[64 + lane] = acg[gi]; ar[128 + lane] = wsg[gi]; }
    f32x16 st, y;
#pragma unroll
    for (int e = 0; e < 16; ++e) { st[e] = 0.f; y[e] = 0.f; }
    unsigned zr[16];
#pragma unroll
    for (int i = 0; i < 16; ++i) zr[i] = 0;
    asm volatile("s_waitcnt vmcnt(0) lgkmcnt(0)" ::: "memory");
    __syncthreads();
    for (int p = 0; p <= 64; ++p) {
        const bool phA = ((p & 1) == team) && (p < 64), phB = ((p & 1) != team) && (p >= 1);
        float ndt = 0.f, nac = 0.f, nws = 0.f;
        if (phA) {
            if (p + 1 < 64) { if (tw == 0) { const size_t gi = (tokb + (size_t)(p + 1) * 64 + lane) * 16 + h; ndt = dtg[gi]; nac = acg[gi]; nws = wsg[gi]; }
                SSD_DMA(p + 1); }
            const char* pz = (const char*)(proj + (tokb + (size_t)p * 64) * NP + PC_Z + h * 64 + pb * 32);
#pragma unroll
            for (int i = 0; i < 16; ++i) zr[i] = *(const unsigned*)(pz + (zoff0 + (unsigned)(((i & 3) + 8 * (i >> 2)) * NP * 2)));
        }
        if (p < 64) {
            const int img = (p % 3) * L_IMG, arr = L_ARR + (p % 3) * 768;
            const int Sw = (p & 1) ? L_S0 : L_S1;
            const float dec = __expf(LDSV(float, arr + 256 + 63 * 4));
#pragma unroll
            for (int e = 0; e < 16; ++e) st[e] *= dec;
#pragma unroll
            for (int ks = 0; ks < 4; ++ks) {
                const u32x2 lo = __builtin_bit_cast(u32x2, ds_tr(lds + img + L_OX + aXlo + ks * 2048)), hi = __builtin_bit_cast(u32x2, ds_tr(lds + img + L_OX + aXhi + ks * 2048));
                const f32x4 w0 = LDSV(f32x4, arr + 512 + (16 * ks) * 4 + hh * 32), w1 = LDSV(f32x4, arr + 512 + (16 * ks + 4) * 4 + hh * 32);
                const bf16x8 bx = pack8(bf_lo(lo.x) * w0[0], bf_hi(lo.x) * w0[1], bf_lo(lo.y) * w0[2], bf_hi(lo.y) * w0[3], bf_lo(hi.x) * w1[0], bf_hi(hi.x) * w1[1], bf_lo(hi.y) * w1[2], bf_hi(hi.y) * w1[3]);
                st = MFMA32(cat8(ds_tr(lds + img + L_OB + aBlo + ks * 4096), ds_tr(lds + img + L_OB + aBhi + ks * 4096)), bx, st); }
#pragma unroll
            for (int q = 0; q < 4; ++q) { u32x2 w; w.x = cvtpk(st[4 * q], st[4 * q + 1]); w.y = cvtpk(st[4 * q + 2], st[4 * q + 3]);
                *(LAS u32x2*)(lds + Sw + aSw + 16 * q) = w; }
        }
        if (phA || phB) {
            const int j = phA ? p : p - 1;
            const int img = (j % 3) * L_IMG, arr = L_ARR + (j % 3) * 768;
            const int cC = img + L_OC + lb * 8192 + aRow;
            const int l = lb * 32 + r; const float al = LDSV(float, arr + 256 + l * 4);
            if (phA) {
                const int Sr = ((p & 1) ? L_S1 : L_S0) + aS;
#pragma unroll
                for (int e = 0; e < 16; ++e) y[e] = 0.f;
#pragma unroll
                for (int k = 0; k < 8; ++k) { y = MFMA32(LDSV(bf16x8, cC ^ (k << 5)), LDSV(bf16x8, Sr + 32 * k), y); if ((k & 3) == 3) asm volatile("" ::: "memory"); }
#pragma unroll
                for (int q = 0; q < 4; ++q) { const f32x4 av = LDSV(f32x4, arr + 256 + (lb * 32 + 8 * q) * 4 + hh * 16);
#pragma unroll
                    for (int e = 0; e < 4; ++e) y[4 * q + e] *= __expf(av[e]); }
            }
            if (phB || lb == 1) {
                const int sb = phB ? lb : 0;
                const int cB = img + L_OB + sb * 8192 + aRow;
                f32x16 cbm;
#pragma unroll
                for (int e = 0; e < 16; ++e) cbm[e] = 0.f;
#pragma unroll
                for (int k = 0; k < 8; ++k) { cbm = MFMA32(LDSV(bf16x8, cB ^ (k << 5)), LDSV(bf16x8, cC ^ (k << 5)), cbm); if ((k & 3) == 3) asm volatile("" ::: "memory"); }
                if (phB) {
#pragma unroll
                    for (int q = 0; q < 4; ++q) { const f32x4 as4 = LDSV(f32x4, arr + 256 + (sb * 32 + 8 * q) * 4 + hh * 16), dt4 = LDSV(f32x4, arr + (sb * 32 + 8 * q) * 4 + hh * 16);
#pragma unroll
                        for (int e = 0; e < 4; ++e) { const int s = 8 * q + 4 * hh + e;
                            float mv = (r >= s) ? cbm[4 * q + e] * __expf(fminf(al - as4[e], 0.f)) * dt4[e] : 0.f;
                            if (r == s) mv += Dh;
                            cbm[4 * q + e] = mv; } }
                } else {
#pragma unroll
                    for (int q = 0; q < 4; ++q) { const f32x4 as4 = LDSV(f32x4, arr + 256 + (8 * q) * 4 + hh * 16), dt4 = LDSV(f32x4, arr + (8 * q) * 4 + hh * 16);
#pragma unroll
                        for (int e = 0; e < 4; ++e) cbm[4 * q + e] = cbm[4 * q + e] * __expf(fminf(al - as4[e], 0.f)) * dt4[e]; }
                }
                const bf16x8 af0 = pack8(cbm[0], cbm[1], cbm[2], cbm[3], cbm[4], cbm[5], cbm[6], cbm[7]);
                const bf16x8 af1 = pack8(cbm[8], cbm[9], cbm[10], cbm[11], cbm[12], cbm[13], cbm[14], cbm[15]);
                { const int xa = img + L_OX + aXt2 + sb * 4096;
                  y = MFMA32(af0, cat8(ds_tr(lds + xa), ds_tr(lds + xa + 1024)), y);
                  y = MFMA32(af1, cat8(ds_tr(lds + xa + 2048), ds_tr(lds + xa + 3072)), y); }
            }
            if (phB) {
                const size_t tokc = tokb + (size_t)j * 64;
                char* pm = (char*)(mix + tokc * MIXW + 512 + h * 64 + pb * 32);
                char* pq = (char*)(ssq + tokc * 32 + h * 2 + pb);
                float sq[16];
#pragma unroll
                for (int i = 0; i < 16; ++i) { const float zf = __uint_as_float((r & 1) ? (zr[i] & 0xffff0000u) : (zr[i] << 16)); const float gv = y[i] * fast_silu(zf);
                    sq[i] = gv * gv;
                    *(bf16_t*)(pm + (moff0 + (unsigned)(((i & 3) + 8 * (i >> 2)) * MIXW * 2))) = (bf16_t)(cvtpk(gv, 0.f) & 0xffffu); }
#pragma unroll
                for (int i = 0; i < 8; ++i) { const bool up = (lane & 16) != 0; const float send = up ? sq[i] : sq[i + 8], keep = up ? sq[i + 8] : sq[i]; sq[i] = keep + __shfl_xor(send, 16); }
#pragma unroll
                for (int i = 0; i < 4; ++i) { const bool up = (lane & 8) != 0; const float send = up ? sq[i] : sq[i + 4], keep = up ? sq[i + 4] : sq[i]; sq[i] = keep + __shfl_xor(send, 8); }
#pragma unroll
                for (int i = 0; i < 2; ++i) { const bool up = (lane & 4) != 0; const float send = up ? sq[i] : sq[i + 2], keep = up ? sq[i + 2] : sq[i]; sq[i] = keep + __shfl_xor(send, 4); }
                { const bool up = (lane & 2) != 0; const float send = up ? sq[0] : sq[1], keep = up ? sq[1] : sq[0]; sq[0] = keep + __shfl_xor(send, 2); }
                sq[0] += __shfl_xor(sq[0], 1);
                if ((lane & 1) == 0) *(float*)(pq + qoff) = sq[0];
            }
        }
        if (phA) {
            if (tw == 0 && p + 1 < 64) { LAS float* ar = (LAS float*)(lds + L_ARR + ((p + 1) % 3) * 768); ar[lane] = ndt; ar[64 + lane] = nac; ar[128 + lane] = nws; }
            asm volatile("s_waitcnt vmcnt(0) lgkmcnt(0)" ::: "memory");
        } else {
            asm volatile("s_waitcnt lgkmcnt(0)" ::: "memory");
        }
        __builtin_amdgcn_s_barrier();
        asm volatile("" ::: "memory");
    }
#undef SSD_DMA
}

__device__ __forceinline__ void phase_final(const Args& a, int lane, int wave) {
    const float* __restrict__ sqp = (const float*)(a.ws + WS_H2SQ); const float* __restrict__ w = a.in[14]; float* __restrict__ out = a.out; const bf16_t* __restrict__ h2b = (const bf16_t*)(a.ws + WS_MIX);
    f32x4 wv[4];
#pragma unroll
    for (int j = 0; j < 4; ++j) wv[j] = *(const f32x4*)(w + j * 256 + lane * 4);
#pragma unroll 4
    for (int row = blockIdx.x * 8 + wave; row < M; row += gridDim.x * 8) {
        float s = sqp[(size_t)row * 16 + (lane & 15)];
        s += __shfl_xor(s, 1); s += __shfl_xor(s, 2); s += __shfl_xor(s, 4); s += __shfl_xor(s, 8);
        const float rr = rsqrtf(s * (1.0f / 1024.0f) + EPS);
        float* orow = out + (size_t)row * DM + lane * 4; const bf16_t* hrow = h2b + (size_t)row * DM + lane * 4;
#pragma unroll
        for (int j = 0; j < 4; ++j) { const u32x2 hw = *(const u32x2*)(hrow + j * 256); f32x4 v = (f32x4){bf_lo(hw.x), bf_hi(hw.x), bf_lo(hw.y), bf_hi(hw.y)}; v = v * rr * wv[j]; *(f32x4*)(orow + j * 256) = v; }
    }
}

#define RLX_AGENT __ATOMIC_RELAXED, __HIP_MEMORY_SCOPE_AGENT
#define XB_TMO      128
#define XB_XCNT(j)  (256  + 64 * (j))
#define XB_XSUB(j)  (1280 + 64 * (j))
#define XB_XGEN(j)  (2304 + 64 * (j))
#define XB_TOP      3328
#define XB_TOPGEN   3392
#define XCD_BAR_WORDS 3456
#define XB_SPIN_CAP (1u << 18)

__device__ __forceinline__ unsigned xb_ld(unsigned* p)              { return __hip_atomic_load(p, __ATOMIC_RELAXED, __HIP_MEMORY_SCOPE_AGENT); }
__device__ __forceinline__ unsigned xb_add(unsigned* p, unsigned v) { return __hip_atomic_fetch_add(p, v, __ATOMIC_RELAXED, __HIP_MEMORY_SCOPE_AGENT); }
__device__ __forceinline__ unsigned xb_xcc_id() { return (unsigned)__builtin_amdgcn_s_getreg((3 << 11) | 20) & 0xFu; }
#define XB_SPIN(cond, bar) do { unsigned _sp = 0; while (cond) { __builtin_amdgcn_s_sleep(1); \
    if ((++_sp & 255u) == 0u) { if (xb_ld(&(bar)[XB_TMO])) break; if (_sp > XB_SPIN_CAP) { atomicAdd(&(bar)[XB_TMO], 1u); break; } } } } while (0)

struct XcdBarrier {
    unsigned* bar; unsigned x;
    volatile LAS unsigned* st;
};

__device__ __forceinline__ XcdBarrier xcd_barrier_post(unsigned* bar, volatile LAS unsigned* st) {
    XcdBarrier b; b.bar = bar; b.x = xb_xcc_id(); b.st = st;
    if (threadIdx.x == 0) (void)xb_add(&bar[XB_XCNT(b.x)], 1u);
    return b;
}
__device__ __forceinline__ void xcd_barrier_complete(unsigned* bar, unsigned x, unsigned& nloc, unsigned& nx) {
    const unsigned G = gridDim.x * gridDim.y * gridDim.z;
    unsigned sum, cnt, mine, sp = 0u;
    for (;;) {
        sum = 0u; cnt = 0u; mine = 0u;
#pragma unroll
        for (unsigned j = 0; j < 16; ++j) { const unsigned c = xb_ld(&bar[XB_XCNT(j)]); sum += c; cnt += (c > 0u) ? 1u : 0u; mine = (j == x) ? c : mine; }
        if (sum == G) break;
        __builtin_amdgcn_s_sleep(1);
        if ((++sp & 255u) == 0u) { if (xb_ld(&bar[XB_TMO])) break; if (sp > XB_SPIN_CAP) { atomicAdd(&bar[XB_TMO], 1u); break; } }
    }
    nloc = mine > 0u ? mine : 1u; nx = cnt > 0u ? cnt : 1u;
}

__device__ __forceinline__ void xcd_barrier(const XcdBarrier& b) {
    asm volatile("s_waitcnt vmcnt(0)" ::: "memory");
    __syncthreads();
    if (threadIdx.x == 0) {
        unsigned* bar = b.bar;
        __builtin_amdgcn_s_waitcnt(0);
        unsigned nloc = b.st[0], nx = b.st[1];
        if (nloc == 0u) { xcd_barrier_complete(bar, b.x, nloc, nx); b.st[0] = nloc; b.st[1] = nx; }
        const unsigned old = xb_add(&bar[XB_XSUB(b.x)], 1u);
        const unsigned gen = old / nloc;
        if (old + 1u == (gen + 1u) * nloc) {
            __builtin_amdgcn_fence(__ATOMIC_RELEASE, "agent");
            asm volatile("s_waitcnt vmcnt(0)" ::: "memory");
            const unsigned og = xb_add(&bar[XB_TOP], 1u);
            const unsigned tg = og / nx;
            if (og + 1u == (tg + 1u) * nx) xb_add(&bar[XB_TOPGEN], 1u);
            else XB_SPIN(xb_ld(&bar[XB_TOPGEN]) == tg, bar);
            __builtin_amdgcn_fence(__ATOMIC_ACQUIRE, "agent");
            xb_add(&bar[XB_XGEN(b.x)], 1u);
            asm volatile("s_waitcnt vmcnt(0)" ::: "memory");
        } else {
            XB_SPIN(xb_ld(&bar[XB_XGEN(b.x)]) == gen, bar);
            __builtin_amdgcn_fence(__ATOMIC_ACQUIRE, "agent");
            asm volatile("s_waitcnt vmcnt(0)" ::: "memory");
        }
    }
    __syncthreads();
}

__global__ void __launch_bounds__(512, 2) mega_fwd(Args args) {
    extern __shared__ __attribute__((aligned(16))) unsigned char lds_raw[];
    LAS unsigned char* lds = (LAS unsigned char*)lds_raw;
    const int tid = threadIdx.x, lane = tid & 63, wave = __builtin_amdgcn_readfirstlane(tid >> 6);
    const int lo = args.ph_lo, hi = args.ph_hi;
    cg::grid_group grid = cg::this_grid();
#ifndef PH_MASK
#define PH_MASK 0xff
#endif
#define IN(k) (((PH_MASK >> (k)) & 1) && lo <= (k) && (k) < hi)
    volatile LAS unsigned* bst = (volatile LAS unsigned*)(lds + LDS_BYTES - 16);
    XcdBarrier bar; bar.bar = (unsigned*)(args.ws + WS_BAR); bar.x = 0; bar.st = bst;
#define SEAM(k) do { if (IN(k) && IN((k) + 1)) xcd_barrier(bar); } while (0)
    unsigned char* ws = args.ws;
    bf16_t* WinT = (bf16_t*)(ws + WS_WIN); bf16_t* WoutT = (bf16_t*)(ws + WS_WOUT); bf16_t* W1T = (bf16_t*)(ws + WS_W1); bf16_t* W2T = (bf16_t*)(ws + WS_W2);
    bf16_t* xn = (bf16_t*)(ws + WS_XN); bf16_t* hb = (bf16_t*)(ws + WS_XN); bf16_t* proj = (bf16_t*)(ws + WS_PROJ); bf16_t* ub = (bf16_t*)(ws + WS_PROJ); bf16_t* mix = (bf16_t*)(ws + WS_MIX);
    float* ssq = (float*)(ws + WS_SSQ); float* hsq = (float*)(ws + WS_HSQ); float* h2sq = (float*)(ws + WS_H2SQ);
    const int G = gridDim.x;

    if (tid < 4) bst[tid] = 0u;
    __syncthreads();
    if (hi - lo > 1) {
        if (blockIdx.x == 0) { unsigned* bw = (unsigned*)(args.ws + WS_BAR); for (int e = tid; e < XCD_BAR_WORDS; e += 512) bw[e] = 0u; }
        grid.sync();
        bar = xcd_barrier_post((unsigned*)(args.ws + WS_BAR), bst);
    }
    if (IN(0)) { phase_prep(args, lds, tid, lane, wave); }
    SEAM(0);
    if (IN(1)) {
        pg8::Gemm g{xn, WinT, M, NP, DM}; pg8::StaticOrder S; S.init(M, NP, G, (int)blockIdx.x);
        pg8::EpiProj E{proj, NP};
        pg8::gemm_phase<pg8::EpiProj, true>(lds, g, S, E);
    }
    SEAM(1);
    if (IN(2)) { for (int u = blockIdx.x; u < 512; u += G) conv_unit(args, u, tid, lane, wave); }
    SEAM(2);
    if (IN(3)) {
        const int nssd = (G >= 256) ? 128 : (G / 2 > 0 ? G / 2 : 1);
        if ((int)blockIdx.x < nssd) {
            if (args.p2mask & 1)
            for (int u = blockIdx.x; u < 128; u += nssd) { ssd_unit(args, u, lds, tid, lane, wave); __syncthreads(); }
        } else {
            if (args.p2mask & 2)
            for (int u = blockIdx.x - nssd; u < 512; u += G - nssd) attn_unit(proj, args.in[3], mix, u, lds, lane, wave);
        }
        __syncthreads();
    }
    SEAM(3);
    if (IN(4)) {
        pg8::Gemm g{mix, WoutT, M, DM, MIXW}; pg8::StaticOrder S; S.init(M, DM, G, (int)blockIdx.x);
        pg8::EpiOut E{args.in[0], args.out, hb, hsq, ssq};
        pg8::gemm_phase<pg8::EpiOut, true>(lds, g, S, E);
    }
    SEAM(4);
    if (IN(5)) {
        pg8::Gemm g{hb, W1T, M, FF, DM}; pg8::StaticOrder S; S.init(M, FF, G, (int)blockIdx.x);
        pg8::EpiFF1 E{ub, FF, hsq};
        pg8::gemm_phase<pg8::EpiFF1, true>(lds, g, S, E);
    }
    SEAM(5);
    if (IN(6)) {
        pg8::Gemm g{ub, W2T, M, DM, FF}; pg8::StaticOrder S; S.init(M, DM, G, (int)blockIdx.x);
        pg8::EpiFF2 E{hb, mix  , h2sq};
        pg8::gemm_phase<pg8::EpiFF2, true>(lds, g, S, E);
    }
    SEAM(6);
    if (IN(7)) { phase_final(args, lane, wave); }
#ifdef EXTRA_SYNCS
    if (hi - lo > 1) { for (int i = 0; i < EXTRA_SYNCS; ++i) grid.sync(); }
#endif
#undef IN
#undef SEAM
}

#ifndef N_LAUNCHES
#define N_LAUNCHES 1
#endif

extern "C" void kernel_launch(void* const* d_in, const int* in_sizes, int n_in, void* d_out, int out_size, void* d_ws, size_t ws_size, hipStream_t stream) {
    static int grid = 0;
    if (grid == 0) {
        if (n_in != 15 || out_size != M * DM || ws_size < WS_END) { fprintf(stderr, "kernel_launch: unexpected shapes (n_in %d out %d ws %zu)\n", n_in, out_size, ws_size); grid = -1; return; }
        int dev = 0, cus = 0, per_cu = 0;
        (void)hipGetDevice(&dev);
        (void)hipDeviceGetAttribute(&cus, hipDeviceAttributeMultiprocessorCount, dev);
        if (hipFuncSetAttribute((const void*)mega_fwd, hipFuncAttributeMaxDynamicSharedMemorySize, LDS_BYTES) != hipSuccess) { fprintf(stderr, "kernel_launch: hipFuncSetAttribute failed\n"); grid = -1; return; }
        if (hipOccupancyMaxActiveBlocksPerMultiprocessor(&per_cu, (const void*)mega_fwd, 512, LDS_BYTES) != hipSuccess || per_cu < 1) { fprintf(stderr, "kernel_launch: occupancy query says %d\n", per_cu); per_cu = 1; }
        (void)hipGetLastError();
        grid = cus * per_cu;
        if (grid <= 0) grid = 256;
    }
    if (grid < 0) return;
    Args a{};
    for (int i = 0; i < 15; ++i) a.in[i] = (const float*)d_in[i];
    a.out = (float*)d_out; a.ws = (unsigned char*)d_ws; a.p2mask = 3;
#ifndef REP_P2MASK
#define REP_P2MASK 3
#endif
#ifdef REP_PHASE
    {
        for (int p = 0; p < NPHASE; ++p) { a.ph_lo = p; a.ph_hi = p + 1; a.p2mask = 3;
            hipLaunchKernelGGL(mega_fwd, dim3(grid), dim3(512), LDS_BYTES, stream, a);
            if (p == REP_PHASE) { a.p2mask = REP_P2MASK; hipLaunchKernelGGL(mega_fwd, dim3(grid), dim3(512), LDS_BYTES, stream, a); } }
        return;
    }
#endif
    if (N_LAUNCHES == 1) {
        a.ph_lo = 0; a.ph_hi = NPHASE;
        void* kargs[] = {&a};
        hipError_t e = hipLaunchCooperativeKernel((const void*)mega_fwd, dim3(grid), dim3(512), kargs, LDS_BYTES, stream);
        if (e != hipSuccess) fprintf(stderr, "cooperative launch failed: %s (grid %d)\n", hipGetErrorString(e), grid);
    } else {
        for (int p = 0; p < NPHASE; ++p) { a.ph_lo = p; a.ph_hi = p + 1;
            hipLaunchKernelGGL(mega_fwd, dim3(grid), dim3(512), LDS_BYTES, stream, a); }
    }
}
```
